# Optimizing an MI355X kernel written in HIP

```python
import math
import jax, jax.numpy as jnp
from jax import lax
import numpy as np

D_MODEL = 1024
BATCH = 1
SEQ = 16384
DEPTH = 1

D_MIX = D_MODEL
RET_WIDTH = D_MIX // 2
RET_HEADS = 8
RET_HEAD_DIM = RET_WIDTH // RET_HEADS
CONV_WIDTH = D_MIX - RET_WIDTH
CONV_GROUPS = 8
CONV_GROUP_DIM = CONV_WIDTH // CONV_GROUPS
SHORT_CONV_K = 3
CHUNK = 128
D_FF = 2816
FFN_CONV_K = 3
ROPE_BASE = 10000.0
EPS = 1e-6
N_MOD = 6
IN_COLS = 4 * RET_WIDTH + 3 * CONV_WIDTH

kernel_name = "hymba_retention_shortconv_convglu_adaln"


def rms_norm(x, g):
    xf = x.astype(jnp.float32)
    y = xf * lax.rsqrt(jnp.mean(xf * xf, axis=-1, keepdims=True) + EPS)
    return (y * g.astype(jnp.float32)).astype(x.dtype)


def group_rms_norm(x, g, n_groups):
    b, s, w = x.shape
    xf = x.astype(jnp.float32).reshape(b, s, n_groups, w // n_groups)
    xf = xf * lax.rsqrt(jnp.mean(xf * xf, axis=-1, keepdims=True) + EPS)
    return (xf.reshape(b, s, w) * g.astype(jnp.float32)).astype(x.dtype)


def modulate(h, shift, scale):
    return h * (1.0 + scale[:, None, :]) + shift[:, None, :]


def causal_dwconv(x, w):
    k = w.shape[0]
    s = x.shape[1]
    xp = jnp.pad(x, ((0, 0), (k - 1, 0), (0, 0)))
    y = xp[:, 0:s, :] * w[0]
    for j in range(1, k):
        y = y + xp[:, j:j + s, :] * w[j]
    return y


def rotary(x, positions):
    half = x.shape[-1] // 2
    inv_freq = ROPE_BASE ** (-jnp.arange(half, dtype=jnp.float32) / half)
    ang = positions.astype(jnp.float32)[..., None] * inv_freq
    cos = jnp.cos(ang)[:, :, None, :]
    sin = jnp.sin(ang)[:, :, None, :]
    xf = x.astype(jnp.float32)
    x1, x2 = xf[..., :half], xf[..., half:]
    return jnp.concatenate([x1 * cos - x2 * sin, x1 * sin + x2 * cos], axis=-1)


def retention_chunkwise(q, k, v):
    b, s, h, dh = q.shape
    nc = s // CHUNK
    log_gamma = jnp.log1p(-jnp.exp2(-5.0 - jnp.arange(h, dtype=jnp.float32)))
    q = q.reshape(b, nc, CHUNK, h, dh)
    k = k.reshape(b, nc, CHUNK, h, dh) * (dh ** -0.5)
    v = v.reshape(b, nc, CHUNK, h, dh)
    idx = jnp.arange(CHUNK, dtype=jnp.float32)
    rel = idx[:, None] - idx[None, :]
    decay_mask = jnp.where(rel[None] >= 0.0,
                           jnp.exp(jnp.maximum(rel, 0.0)[None] * log_gamma[:, None, None]),
                           0.0)
    scores = jnp.einsum('bnqhd,bnkhd->bnhqk', q, k) * decay_mask[None, None]
    y_inner = jnp.einsum('bnhqk,bnkhd->bnqhd', scores, v)
    zeta = jnp.exp((CHUNK - 1.0 - idx)[None, :] * log_gamma[:, None])
    kv_chunk = jnp.einsum('bnkhd,hk,bnkhe->bnhde', k, zeta, v)
    chunk_decay = jnp.exp(CHUNK * log_gamma)[None, :, None, None]

    def step(state, kv):
        return state * chunk_decay + kv, state

    init = jnp.zeros((b, h, dh, dh), dtype=jnp.float32)
    _, r_prev = lax.scan(step, init, jnp.moveaxis(kv_chunk, 1, 0))
    r_prev = jnp.moveaxis(r_prev, 0, 1)
    xi = jnp.exp((idx + 1.0)[None, :] * log_gamma[:, None])
    y_cross = jnp.einsum('bnqhd,bnhde,hq->bnqhe', q, r_prev, xi)
    return (y_inner + y_cross).reshape(b, s, h, dh)


def setup_inputs(seed: int = 0) -> dict:
    key = jax.random.key(seed)
    ks = jax.random.split(key, 20)
    f32 = jnp.float32
    d = D_MODEL

    def nrm(k, shape, scale):
        return jax.random.normal(k, shape, dtype=f32) * scale

    x = nrm(ks[0], (BATCH, SEQ, d), 1.0)
    c = nrm(ks[1], (BATCH, d), 1.0)
    positions = jnp.broadcast_to(jnp.arange(SEQ, dtype=jnp.int32)[None, :], (BATCH, SEQ))
    return {
        "x": x,
        "c": c,
        "positions": positions,
        "mod_w": nrm(ks[2], (DEPTH, d, N_MOD * d), 0.5 * d ** -0.5),
        "mod_b": nrm(ks[3], (DEPTH, N_MOD * d), 0.01),
        "norm1_g": 1.0 + nrm(ks[4], (DEPTH, d), 0.02),
        "w_in": nrm(ks[5], (DEPTH, d, IN_COLS), d ** -0.5),
        "ret_norm_g": 1.0 + nrm(ks[6], (DEPTH, RET_WIDTH), 0.02),
        "short_conv_w": nrm(ks[7], (DEPTH, SHORT_CONV_K, CONV_WIDTH), SHORT_CONV_K ** -0.5),
        "conv_norm_g": 1.0 + nrm(ks[8], (DEPTH, CONV_WIDTH), 0.02),
        "w_out": nrm(ks[9], (DEPTH, D_MIX, d), D_MIX ** -0.5),
        "norm2_g": 1.0 + nrm(ks[10], (DEPTH, d), 0.02),
        "w_up": nrm(ks[11], (DEPTH, d, 2 * D_FF), d ** -0.5),
        "ffn_conv_w": nrm(ks[12], (DEPTH, FFN_CONV_K, D_FF), FFN_CONV_K ** -0.5),
        "ffn_conv_b": nrm(ks[13], (DEPTH, D_FF), 0.01),
        "w_down": nrm(ks[14], (DEPTH, D_FF, d), D_FF ** -0.5),
        "final_mod_w": nrm(ks[15], (d, 2 * d), 0.5 * d ** -0.5),
        "final_mod_b": nrm(ks[16], (2 * d,), 0.01),
        "final_norm_g": 1.0 + nrm(ks[17], (d,), 0.02),
    }


def reference(x, c, positions, mod_w, mod_b, norm1_g, w_in, ret_norm_g, short_conv_w,
              conv_norm_g, w_out, norm2_g, w_up, ffn_conv_w, ffn_conv_b, w_down,
              final_mod_w, final_mod_b, final_norm_g):
    b, s, d = x.shape
    c_act = jax.nn.silu(c)
    for layer in range(DEPTH):
        mod = (c_act @ mod_w[layer] + mod_b[layer]).reshape(b, N_MOD, d)
        shift1, scale1, gate1 = mod[:, 0], mod[:, 1], mod[:, 2]
        shift2, scale2, gate2 = mod[:, 3], mod[:, 4], mod[:, 5]

        h = modulate(rms_norm(x, norm1_g[layer]), shift1, scale1)
        proj = h @ w_in[layer]
        q, k, v, g, cb, cc, cx = jnp.split(
            proj,
            [RET_WIDTH, 2 * RET_WIDTH, 3 * RET_WIDTH, 4 * RET_WIDTH,
             4 * RET_WIDTH + CONV_WIDTH, 4 * RET_WIDTH + 2 * CONV_WIDTH],
            axis=-1)
        q = rotary(q.reshape(b, s, RET_HEADS, RET_HEAD_DIM), positions)
        k = rotary(k.reshape(b, s, RET_HEADS, RET_HEAD_DIM), positions)
        v = v.reshape(b, s, RET_HEADS, RET_HEAD_DIM).astype(jnp.float32)
        y_ret = retention_chunkwise(q, k, v).reshape(b, s, RET_WIDTH).astype(x.dtype)
        y_ret = group_rms_norm(y_ret, ret_norm_g[layer], RET_HEADS) * jax.nn.silu(g)
        y_conv = cb * causal_dwconv(cc * cx, short_conv_w[layer])
        y_conv = group_rms_norm(y_conv, conv_norm_g[layer], CONV_GROUPS)
        mixed = jnp.concatenate([y_ret, y_conv], axis=-1) @ w_out[layer]
        x = x + gate1[:, None, :] * mixed

        h = modulate(rms_norm(x, norm2_g[layer]), shift2, scale2)
        up = h @ w_up[layer]
        a, val = up[..., :D_FF], up[..., D_FF:]
        a = causal_dwconv(a, ffn_conv_w[layer]) + ffn_conv_b[layer]
        ffn = (jax.nn.silu(a) * val) @ w_down[layer]
        x = x + gate2[:, None, :] * ffn

    fmod = (c_act @ final_mod_w + final_mod_b).reshape(b, 2, d)
    return modulate(rms_norm(x, final_norm_g), fmod[:, 0], fmod[:, 1])
```

```cpp
#include <hip/hip_runtime.h>
#include <cstdio>
#include <cstdint>

namespace {
constexpr int D = 1024, S = 16384, M = S;
constexpr int RW = 512, RH = 8, HD = 64, CW = 512, CG = 8;
constexpr int CHUNK = 128, NC = S / CHUNK;
constexpr int DFF = 2816, INC = 3584, NMOD = 6;
constexpr float EPS = 1e-6f;

__device__ __forceinline__ float silu(float v) { return v / (1.0f + expf(-v)); }

__global__ void k_mod(const float* c, const float* W, const float* b, float* out, int N) {
    int j = blockIdx.x * blockDim.x + threadIdx.x; if (j >= N) return;
    float s = 0.f;
    for (int i = 0; i < D; ++i) { s += silu(c[i]) * W[(size_t)i * N + j]; }
    out[j] = s + b[j];
}

__global__ void k_norm_mod(const float* x, const float* g, const float* shift, const float* scale, float* out) {
    __shared__ float red[4];
    const int row = blockIdx.x, t = threadIdx.x;
    const float4 v = ((const float4*)(x + (size_t)row * D))[t];
    float s = v.x * v.x + v.y * v.y + v.z * v.z + v.w * v.w;
    for (int o = 32; o > 0; o >>= 1) s += __shfl_xor(s, o);
    if ((t & 63) == 0) red[t >> 6] = s;
    __syncthreads();
    s = red[0] + red[1] + red[2] + red[3];
    const float r = rsqrtf(s * (1.0f / D) + EPS);
    const float4 gg = ((const float4*)g)[t], sh = ((const float4*)shift)[t], sc = ((const float4*)scale)[t];
    float4 o;
    o.x = (v.x * r * gg.x) * (1.f + sc.x) + sh.x; o.y = (v.y * r * gg.y) * (1.f + sc.y) + sh.y;
    o.z = (v.z * r * gg.z) * (1.f + sc.z) + sh.z; o.w = (v.w * r * gg.w) * (1.f + sc.w) + sh.w;
    ((float4*)(out + (size_t)row * D))[t] = o;
}

struct EStore { float* C; long long ldc; __device__ void operator()(int r, int c, float v) const { C[(size_t)r * ldc + c] = v; } };
struct EResid { const float* X; float* C; long long ldc; const float* gate; __device__ void operator()(int r, int c, float v) const { C[(size_t)r * ldc + c] = X[(size_t)r * ldc + c] + gate[c] * v; } };

template <class Epi> __global__ void __launch_bounds__(256) k_gemm(const float* A, int lda, const float* B, int ldb, int Mr, int N, int K, Epi epi) {
    __shared__ float As[16][68];
    __shared__ float Bs[16][64];
    const int tid = threadIdx.x, tx = tid & 15, ty = tid >> 4;
    const int m0 = blockIdx.y * 64, n0 = blockIdx.x * 64;
    float acc[4][4];
#pragma unroll
    for (int i = 0; i < 4; ++i)
#pragma unroll
        for (int j = 0; j < 4; ++j) acc[i][j] = 0.f;
    const int ar = tid >> 2, ak = (tid & 3) * 4;
    const int bk = tid >> 4, bn = (tid & 15) * 4;
    for (int k0 = 0; k0 < K; k0 += 16) {
        float4 av = make_float4(0.f, 0.f, 0.f, 0.f);
        if (m0 + ar < Mr) av = *(const float4*)(A + (size_t)(m0 + ar) * lda + k0 + ak);
        const float4 bv = *(const float4*)(B + (size_t)(k0 + bk) * ldb + n0 + bn);
        __syncthreads();
        As[ak + 0][ar] = av.x; As[ak + 1][ar] = av.y; As[ak + 2][ar] = av.z; As[ak + 3][ar] = av.w;
        *(float4*)&Bs[bk][bn] = bv;
        __syncthreads();
#pragma unroll
        for (int kk = 0; kk < 16; ++kk) {
            const float4 a = *(const float4*)&As[kk][ty * 4];
            const float4 b = *(const float4*)&Bs[kk][tx * 4];
            const float aa[4] = {a.x, a.y, a.z, a.w}, bb[4] = {b.x, b.y, b.z, b.w};
#pragma unroll
            for (int i = 0; i < 4; ++i)
#pragma unroll
                for (int j = 0; j < 4; ++j) acc[i][j] += aa[i] * bb[j];
        }
    }
#pragma unroll
    for (int i = 0; i < 4; ++i) { const int r = m0 + ty * 4 + i; if (r < Mr) {
#pragma unroll
        for (int j = 0; j < 4; ++j) epi(r, n0 + tx * 4 + j, acc[i][j]); } }
}

__global__ void k_rotary(float* proj, const int* pos) {
    const int idx = blockIdx.x * blockDim.x + threadIdx.x;
    if (idx >= S * 16 * 32) return;
    const int i = idx & 31, hh = (idx >> 5) & 15, t = idx >> 9;
    const float inv_freq = powf(10000.0f, -(float)i / 32.0f);
    const float ang = (float)pos[t] * inv_freq;
    const float cs = cosf(ang), sn = sinf(ang);
    float* p = proj + (size_t)t * INC + hh * 64 + i;
    const float x1 = p[0], x2 = p[32];
    const float sc = hh >= 8 ? 0.125f : 1.0f;
    p[0] = (x1 * cs - x2 * sn) * sc; p[32] = (x1 * sn + x2 * cs) * sc;
}

__device__ __forceinline__ float log_gamma(int h) { return log1pf(-exp2f(-5.0f - (float)h)); }

__global__ void __launch_bounds__(256) k_kv(const float* proj, float* kv) {
    const int n = blockIdx.x, h = blockIdx.y, tid = threadIdx.x, d = tid >> 2, e0 = (tid & 3) * 16;
    const float lg = log_gamma(h);
    float acc[16];
#pragma unroll
    for (int j = 0; j < 16; ++j) acc[j] = 0.f;
    for (int m = 0; m < CHUNK; ++m) {
        const float* row = proj + (size_t)(n * CHUNK + m) * INC;
        const float kd = row[RW + h * 64 + d] * expf((float)(CHUNK - 1 - m) * lg);
        const float* vp = row + 2 * RW + h * 64 + e0;
#pragma unroll
        for (int j = 0; j < 16; ++j) acc[j] += kd * vp[j];
    }
    float* o = kv + ((size_t)(h * NC + n) * 64 + d) * 64 + e0;
#pragma unroll
    for (int j = 0; j < 16; ++j) o[j] = acc[j];
}

__global__ void k_scan(float* kv) {
    const int idx = blockIdx.x * blockDim.x + threadIdx.x;
    const int h = idx >> 12, e = idx & 4095;
    const float cd = expf((float)CHUNK * log_gamma(h));
    float st = 0.f;
    for (int n = 0; n < NC; ++n) { float* p = kv + (size_t)(h * NC + n) * 4096 + e; const float t = *p; *p = st; st = st * cd + t; }
}

__global__ void __launch_bounds__(128) k_ret_out(const float* proj, const float* rprev, const float* gn_g, float* ymix) {
    __shared__ float ks[CHUNK][64];
    __shared__ float vs[CHUNK][64];
    __shared__ float qs[CHUNK][65];
    const int n = blockIdx.x, h = blockIdx.y, i = threadIdx.x;
    const float lg = log_gamma(h);
    for (int idx = i; idx < CHUNK * 64; idx += 128) { const int r = idx >> 6, cc = idx & 63; const float* row = proj + (size_t)(n * CHUNK + r) * INC + h * 64 + cc;
        qs[r][cc] = row[0]; ks[r][cc] = row[RW]; vs[r][cc] = row[2 * RW]; }
    __syncthreads();
    float y[64];
#pragma unroll
    for (int e = 0; e < 64; ++e) y[e] = 0.f;
    for (int j = 0; j <= i; ++j) {
        float s = 0.f;
        for (int d = 0; d < 64; ++d) s += qs[i][d] * ks[j][d];
        s *= expf((float)(i - j) * lg);
#pragma unroll
        for (int e = 0; e < 64; ++e) y[e] += s * vs[j][e];
    }
    const float xi = expf((float)(i + 1) * lg);
    const float* R = rprev + (size_t)(h * NC + n) * 4096;
    for (int d = 0; d < 64; ++d) { const float qd = qs[i][d] * xi;
#pragma unroll
        for (int e = 0; e < 64; ++e) y[e] += qd * R[d * 64 + e]; }
    float ss = 0.f;
#pragma unroll
    for (int e = 0; e < 64; ++e) ss += y[e] * y[e];
    const float r = rsqrtf(ss * (1.0f / 64.0f) + EPS);
    const size_t t = (size_t)(n * CHUNK + i);
    const float* gate = proj + t * INC + 3 * RW + h * 64;
    float* o = ymix + t * D + h * 64;
#pragma unroll
    for (int e = 0; e < 64; ++e) o[e] = y[e] * r * gn_g[h * 64 + e] * silu(gate[e]);
}

__global__ void k_conv(const float* proj, const float* cw, const float* gn_g, float* ymix) {
    const int idx = blockIdx.x * blockDim.x + threadIdx.x; if (idx >= S * CG) return;
    const int gi = idx & 7, t = idx >> 3;
    const int c0 = gi * 64;
    float ss = 0.f;
    for (int pass = 0; pass < 2; ++pass) {
        float r = 0.f; if (pass) r = rsqrtf(ss * (1.0f / 64.0f) + EPS);
        for (int cc = 0; cc < 64; ++cc) {
            const int c = c0 + cc;
            float a = 0.f;
            for (int j = 0; j < 3; ++j) { const int tt = t - 2 + j; if (tt >= 0) { const float* row = proj + (size_t)tt * INC + 4 * RW; a += cw[j * CW + c] * (row[CW + c] * row[2 * CW + c]); } }
            const float yv = proj[(size_t)t * INC + 4 * RW + c] * a;
            if (!pass) ss += yv * yv; else ymix[(size_t)t * D + RW + c] = yv * r * gn_g[c];
        }
    }
}

__global__ void k_glu(const float* up, int g0, int r0, int nrows, const float* cw, const float* cb, float* act) {
    const size_t idx = (size_t)blockIdx.x * blockDim.x + threadIdx.x; if (idx >= (size_t)nrows * DFF) return;
    const int c = (int)(idx % DFF); const int lr = (int)(idx / DFF); const int t = r0 + lr;
    float a = cb[c];
    for (int j = 0; j < 3; ++j) { const int tt = t - 2 + j; if (tt >= 0) a += cw[j * DFF + c] * up[(size_t)(tt - g0) * (2 * DFF) + c]; }
    act[(size_t)lr * DFF + c] = silu(a) * up[(size_t)(t - g0) * (2 * DFF) + DFF + c];
}
}

extern "C" void kernel_launch(void* const* d_in, const int* in_sizes, int n_in, void* d_out, int out_size, void* d_ws, size_t ws_size, hipStream_t stream) {
    const float* x = (const float*)d_in[0]; const float* c = (const float*)d_in[1]; const int* pos = (const int*)d_in[2];
    const float* mod_w = (const float*)d_in[3]; const float* mod_b = (const float*)d_in[4]; const float* norm1_g = (const float*)d_in[5];
    const float* w_in = (const float*)d_in[6]; const float* ret_g = (const float*)d_in[7]; const float* scw = (const float*)d_in[8];
    const float* conv_g = (const float*)d_in[9]; const float* w_out = (const float*)d_in[10]; const float* norm2_g = (const float*)d_in[11];
    const float* w_up = (const float*)d_in[12]; const float* fcw = (const float*)d_in[13]; const float* fcb = (const float*)d_in[14];
    const float* w_down = (const float*)d_in[15]; const float* fmw = (const float*)d_in[16]; const float* fmb = (const float*)d_in[17];
    const float* fng = (const float*)d_in[18];
    float* out = (float*)d_out; char* ws = (char*)d_ws;
    const size_t MiB = 1u << 20;
    float* proj = (float*)ws;
    float* kv = (float*)(ws + 224 * MiB);
    float* mod = (float*)(ws + 240 * MiB);
    float* fmod = mod + NMOD * D;
    float* x1 = (float*)ws;
    float* upc = (float*)(ws + 64 * MiB);
    float* actc = (float*)(ws + 153 * MiB);
    float* tmp = out;

    k_mod<<<NMOD * D / 256, 256, 0, stream>>>(c, mod_w, mod_b, mod, NMOD * D);
    k_mod<<<2 * D / 256, 256, 0, stream>>>(c, fmw, fmb, fmod, 2 * D);
    k_norm_mod<<<M, 256, 0, stream>>>(x, norm1_g, mod + 0 * D, mod + 1 * D, tmp);
    k_gemm<EStore><<<dim3(INC / 64, M / 64), 256, 0, stream>>>(tmp, D, w_in, INC, M, INC, D, EStore{proj, INC});
    k_rotary<<<S * 16 * 32 / 256, 256, 0, stream>>>(proj, pos);
    k_kv<<<dim3(NC, RH), 256, 0, stream>>>(proj, kv);
    k_scan<<<RH * 4096 / 256, 256, 0, stream>>>(kv);
    k_ret_out<<<dim3(NC, RH), 128, 0, stream>>>(proj, kv, ret_g, tmp);
    k_conv<<<S * CG / 256, 256, 0, stream>>>(proj, scw, conv_g, tmp);
    k_gemm<EResid><<<dim3(D / 64, M / 64), 256, 0, stream>>>(tmp, D, w_out, D, M, D, D, EResid{x, x1, D, mod + 2 * D});
    k_norm_mod<<<M, 256, 0, stream>>>(x1, norm2_g, mod + 3 * D, mod + 4 * D, tmp);
    const int RC = 4096;
    for (int r0 = 0; r0 < M; r0 += RC) {
        const int g0 = r0 == 0 ? 0 : r0 - 2, nr = r0 + RC - g0;
        k_gemm<EStore><<<dim3(2 * DFF / 64, (nr + 63) / 64), 256, 0, stream>>>(tmp + (size_t)g0 * D, D, w_up, 2 * DFF, nr, 2 * DFF, D, EStore{upc, 2 * DFF});
        k_glu<<<(unsigned)(((size_t)RC * DFF + 255) / 256), 256, 0, stream>>>(upc, g0, r0, RC, fcw, fcb, actc);
        k_gemm<EResid><<<dim3(D / 64, RC / 64), 256, 0, stream>>>(actc, DFF, w_down, D, RC, D, DFF, EResid{x1 + (size_t)r0 * D, x1 + (size_t)r0 * D, D, mod + 5 * D});
    }
    k_norm_mod<<<M, 256, 0, stream>>>(x1, fng, fmod, fmod + D, out);
}
```
